# Optimizing an MI355X kernel written in HIP

```python
import math
import jax, jax.numpy as jnp
from jax import lax
import numpy as np

D_MODEL = 2048
BATCH = 2
SEQ = 8192
DEPTH = 1

GRID_W = 64
CTX_LEN = 256
ROWS_PER_CHUNK = 2
CHUNK = ROWS_PER_CHUNK * GRID_W
D_MIX = D_MODEL
W_A = D_MIX // 2
HEAD_DIM_A = 128
N_HEADS_A = W_A // HEAD_DIM_A
W_B = D_MIX - W_A
S5_CH = 16
S5_GROUPS = W_B // S5_CH
S5_STATE = 64
N_DIR = 2
IN_COLS = 3 * W_A + 2 * W_B
ALPHA = (2.0 * DEPTH) ** 0.25
OUT_INIT_SCALE = (8.0 * DEPTH) ** -0.25
LN_EPS = 1e-6
F32 = jnp.float32

kernel_name = "hybrid_gmlp_s5_parallel_heads_deepnorm"


def _layer_norm(x):
    x32 = x.astype(F32)
    mu = jnp.mean(x32, axis=-1, keepdims=True)
    var = jnp.mean(jnp.square(x32 - mu), axis=-1, keepdims=True)
    return ((x32 - mu) * lax.rsqrt(var + LN_EPS)).astype(x.dtype)


def _modulate(x, shift, scale):
    return _layer_norm(x) * (1 + scale[:, None, :]) + shift[:, None, :]


def _chunk_mlp(uv, n_chunks, ln_g, ln_b, w_s, b_s):
    bsz = uv.shape[0]
    u, v = jnp.split(jax.nn.gelu(uv, approximate=False), 2, axis=-1)
    v = _layer_norm(v) * ln_g + ln_b
    v = v.reshape(bsz, n_chunks, CHUNK, N_HEADS_A, HEAD_DIM_A)
    mixed = jnp.einsum("hpq,bnqhd->bnphd", w_s, v) + b_s.T[None, None, :, :, None]
    return u * mixed.reshape(bsz, n_chunks * CHUNK, W_A)


def _s5_discretize(lam_re, lam_im, log_step, b_re, b_im):
    step = jnp.exp(log_step.astype(F32))[:, None]
    lr, li = lam_re.astype(F32), lam_im.astype(F32)
    dr, di = lr * step, li * step
    mag = jnp.exp(dr)
    ab_re, ab_im = mag * jnp.cos(di), mag * jnp.sin(di)
    den = lr * lr + li * li
    nr, ni = ab_re - 1.0, ab_im
    f_re = (nr * lr + ni * li) / den
    f_im = (ni * lr - nr * li) / den
    br, bi = b_re.astype(F32), b_im.astype(F32)
    bb_re = f_re[..., None] * br - f_im[..., None] * bi
    bb_im = f_re[..., None] * bi + f_im[..., None] * br
    return ab_re, ab_im, bb_re, bb_im


def _ssm_combine(e1, e2):
    a1r, a1i, b1r, b1i = e1
    a2r, a2i, b2r, b2i = e2
    ar = a1r * a2r - a1i * a2i
    ai = a1r * a2i + a1i * a2r
    br = a2r * b1r - a2i * b1i + b2r
    bi = a2r * b1i + a2i * b1r + b2i
    return ar, ai, br, bi


def _s5_scan(u, ab_re, ab_im, bb_re, bb_im, h0):
    bu_re = jnp.einsum("lbgc,gpc->lbgp", u, bb_re)
    bu_im = jnp.einsum("lbgc,gpc->lbgp", u, bb_im)
    if h0 is not None:
        h0_re, h0_im = h0
        bu_re = bu_re.at[0].add(ab_re * h0_re - ab_im * h0_im)
        bu_im = bu_im.at[0].add(ab_re * h0_im + ab_im * h0_re)
    length = u.shape[0]
    a_re = jnp.broadcast_to(ab_re, (length, 1) + ab_re.shape)
    a_im = jnp.broadcast_to(ab_im, (length, 1) + ab_im.shape)
    _, _, h_re, h_im = lax.associative_scan(_ssm_combine, (a_re, a_im, bu_re, bu_im), axis=0)
    return h_re, h_im


def _s5_readout(h_re, h_im, c_re, c_im):
    return (jnp.einsum("lbgp,gcp->lbgc", h_re, c_re.astype(F32))
            - jnp.einsum("lbgp,gcp->lbgc", h_im, c_im.astype(F32)))


def _s5_branch(u_lat, u_ctx, lam_re, lam_im, log_step, b_re, b_im, c_re, c_im,
               d_skip, w_glu, b_glu, with_ctx_out):
    def to_lbgc(u):
        bsz, length, _ = u.shape
        return u.astype(F32).reshape(bsz, length, S5_GROUPS, S5_CH).transpose(1, 0, 2, 3)

    ul, uc = to_lbgc(u_lat), to_lbgc(u_ctx)
    ys_lat, ys_ctx = [], []
    for d in range(N_DIR):
        ab_re, ab_im, bb_re, bb_im = _s5_discretize(lam_re[d], lam_im[d], log_step[d], b_re[d], b_im[d])
        ucd, uld = (uc, ul) if d == 0 else (uc[::-1], ul[::-1])
        hc_re, hc_im = _s5_scan(ucd, ab_re, ab_im, bb_re, bb_im, None)
        hl_re, hl_im = _s5_scan(uld, ab_re, ab_im, bb_re, bb_im, (hc_re[-1], hc_im[-1]))
        yl = _s5_readout(hl_re, hl_im, c_re[d], c_im[d])
        ys_lat.append(yl if d == 0 else yl[::-1])
        if with_ctx_out:
            yc = _s5_readout(hc_re, hc_im, c_re[d], c_im[d])
            ys_ctx.append(yc if d == 0 else yc[::-1])

    d_grp = d_skip.astype(F32).reshape(S5_GROUPS, S5_CH)

    def finish(y, u, dtype):
        y = y + d_grp * u
        length, bsz = y.shape[0], y.shape[1]
        y = y.transpose(1, 0, 2, 3).reshape(bsz, length, W_B)
        y = jax.nn.gelu(y, approximate=False).astype(dtype)
        return y * jax.nn.sigmoid(y @ w_glu + b_glu)

    y_lat = finish(ys_lat[0] + ys_lat[1], ul, u_lat.dtype)
    y_ctx = finish(ys_ctx[0] + ys_ctx[1], uc, u_ctx.dtype) if with_ctx_out else None
    return y_lat, y_ctx


def setup_inputs(seed: int = 0) -> dict:
    key = jax.random.key(seed)
    ks = jax.random.split(key, 24)
    nrm = jax.random.normal
    D = D_MODEL
    x = nrm(ks[0], (BATCH, SEQ, D), F32)
    c = nrm(ks[1], (BATCH, D), F32)
    ctx = nrm(ks[2], (BATCH, CTX_LEN, D), F32)
    c_ctx = nrm(ks[3], (D,), F32)
    w_ada = nrm(ks[4], (DEPTH, D, 3 * D), F32) * (D ** -0.5) * 0.5
    b_ada = 0.02 * nrm(ks[5], (DEPTH, 3 * D), F32) + jnp.concatenate(
        [jnp.zeros((2 * D,), F32), jnp.ones((D,), F32)])[None]
    w_in = nrm(ks[6], (DEPTH, D, IN_COLS), F32) * (D ** -0.5)
    sgu_ln_g = 1.0 + 0.02 * nrm(ks[7], (DEPTH, W_A), F32)
    sgu_ln_b = 0.02 * nrm(ks[8], (DEPTH, W_A), F32)
    w_spatial = nrm(ks[9], (DEPTH, N_HEADS_A, CHUNK, CHUNK), F32) * (CHUNK ** -0.5)
    b_spatial = 1.0 + 0.02 * nrm(ks[10], (DEPTH, N_HEADS_A, CHUNK), F32)
    n_idx = jnp.arange(S5_STATE, dtype=F32)
    s5_shape = (DEPTH, N_DIR, S5_GROUPS, S5_STATE)
    s5_lam_re = -0.5 + 0.01 * nrm(ks[11], s5_shape, F32)
    s5_lam_im = math.pi * n_idx + 0.01 * nrm(ks[12], s5_shape, F32)
    s5_log_step = jax.random.uniform(ks[13], (DEPTH, N_DIR, S5_GROUPS), F32,
                                     minval=math.log(1e-3), maxval=math.log(1e-1))
    b_shape = (DEPTH, N_DIR, S5_GROUPS, S5_STATE, S5_CH)
    s5_b_re = nrm(ks[14], b_shape, F32) * ((2 * S5_CH) ** -0.5)
    s5_b_im = nrm(ks[15], b_shape, F32) * ((2 * S5_CH) ** -0.5)
    c_shape = (DEPTH, N_DIR, S5_GROUPS, S5_CH, S5_STATE)
    s5_c_re = nrm(ks[16], c_shape, F32) * (0.5 ** 0.5)
    s5_c_im = nrm(ks[17], c_shape, F32) * (0.5 ** 0.5)
    s5_d = nrm(ks[18], (DEPTH, W_B), F32)
    w_glu = nrm(ks[19], (DEPTH, W_B, W_B), F32) * (W_B ** -0.5)
    b_glu = 0.02 * nrm(ks[20], (DEPTH, W_B), F32)
    w_out = nrm(ks[21], (DEPTH, D_MIX, D), F32) * (D_MIX ** -0.5) * OUT_INIT_SCALE
    ln_g = 1.0 + 0.02 * nrm(ks[22], (DEPTH, D), F32)
    ln_b = 0.02 * nrm(ks[23], (DEPTH, D), F32)
    return {"x": x, "c": c, "ctx": ctx, "c_ctx": c_ctx,
            "w_ada": w_ada, "b_ada": b_ada, "w_in": w_in,
            "sgu_ln_g": sgu_ln_g, "sgu_ln_b": sgu_ln_b,
            "w_spatial": w_spatial, "b_spatial": b_spatial,
            "s5_lam_re": s5_lam_re, "s5_lam_im": s5_lam_im, "s5_log_step": s5_log_step,
            "s5_b_re": s5_b_re, "s5_b_im": s5_b_im, "s5_c_re": s5_c_re, "s5_c_im": s5_c_im,
            "s5_d": s5_d, "w_glu": w_glu, "b_glu": b_glu, "w_out": w_out,
            "ln_g": ln_g, "ln_b": ln_b}


def reference(x, c, ctx, c_ctx, w_ada, b_ada, w_in, sgu_ln_g, sgu_ln_b, w_spatial, b_spatial,
              s5_lam_re, s5_lam_im, s5_log_step, s5_b_re, s5_b_im, s5_c_re, s5_c_im,
              s5_d, w_glu, b_glu, w_out, ln_g, ln_b):
    rows = x.shape[1] // GRID_W
    n_chunks_lat = rows // ROWS_PER_CHUNK
    n_chunks_ctx = ctx.shape[1] // CHUNK
    col_b0, col_b1 = 3 * W_A, 3 * W_A + W_B
    for i in range(DEPTH):
        update_ctx = i < DEPTH - 1
        mod_x = jax.nn.silu(c) @ w_ada[i] + b_ada[i]
        mod_c = (jax.nn.silu(c_ctx) @ w_ada[i] + b_ada[i])[None]
        shift_x, scale_x, gate_x = jnp.split(mod_x, 3, axis=-1)
        shift_c, scale_c, gate_c = jnp.split(mod_c, 3, axis=-1)

        proj_x = _modulate(x, shift_x, scale_x) @ w_in[i]
        hc = _modulate(ctx, shift_c, scale_c)
        ub_c = hc @ w_in[i][:, col_b0:col_b1]
        uv_x, za_x = proj_x[..., :2 * W_A], proj_x[..., 2 * W_A:col_b0]
        ub_x, zb_x = proj_x[..., col_b0:col_b1], proj_x[..., col_b1:]

        ya_x = _chunk_mlp(uv_x, n_chunks_lat, sgu_ln_g[i], sgu_ln_b[i],
                          w_spatial[i], b_spatial[i]) * jax.nn.silu(za_x)
        yb_x, yb_c = _s5_branch(ub_x, ub_c, s5_lam_re[i], s5_lam_im[i], s5_log_step[i],
                                s5_b_re[i], s5_b_im[i], s5_c_re[i], s5_c_im[i],
                                s5_d[i], w_glu[i], b_glu[i], update_ctx)
        yb_x = yb_x * jax.nn.silu(zb_x)

        out_x = jnp.concatenate([ya_x, yb_x], axis=-1) @ w_out[i]
        x_new = _layer_norm(ALPHA * x + gate_x[:, None, :] * out_x) * ln_g[i] + ln_b[i]

        if update_ctx:
            rest_c = hc @ w_in[i]
            ya_c = _chunk_mlp(rest_c[..., :2 * W_A], n_chunks_ctx, sgu_ln_g[i], sgu_ln_b[i],
                              w_spatial[i], b_spatial[i]) * jax.nn.silu(rest_c[..., 2 * W_A:col_b0])
            yb_c = yb_c * jax.nn.silu(rest_c[..., col_b1:])
            out_c = jnp.concatenate([ya_c, yb_c], axis=-1) @ w_out[i]
            ctx = _layer_norm(ALPHA * ctx + gate_c[:, None, :] * out_c) * ln_g[i] + ln_b[i]
        x = x_new
    return x
```

```cpp
#include <hip/hip_runtime.h>
#include <math.h>

namespace {
constexpr int D = 2048, NB = 2, L = 8192, LC = 256, WA = 1024, WB = 1024, NH = 8, G = 64, P = 64, INC = 5120;
constexpr int M = NB * L;
constexpr int MC = NB * LC;
constexpr float LN_EPS = 1e-6f;
constexpr float ALPHA = 1.189207115002721f;

__device__ __forceinline__ float silu_f(float v) { return v / (1.f + expf(-v)); }
__device__ __forceinline__ float gelu_f(float v) { return 0.5f * v * (1.f + erff(v * 0.7071067811865476f)); }
__device__ __forceinline__ float sigmoid_f(float v) { return 1.f / (1.f + expf(-v)); }

__device__ __forceinline__ float block_sum_256(float v, float* red) {
    for (int o = 32; o > 0; o >>= 1) v += __shfl_down(v, o);
    const int w = threadIdx.x >> 6, l = threadIdx.x & 63;
    __syncthreads();
    if (l == 0) red[w] = v;
    __syncthreads();
    return red[0] + red[1] + red[2] + red[3];
}

__global__ void k_mod(const float* c, const float* cctx, const float* w_ada, const float* b_ada, float* mod) {
    const int idx = blockIdx.x * 256 + threadIdx.x; if (idx >= 3 * 6144) return;
    const int r = idx / 6144, n = idx % 6144;
    const float* v = r < 2 ? c + r * D : cctx;
    float acc = 0.f;
    for (int k = 0; k < D; ++k) acc += silu_f(v[k]) * w_ada[(size_t)k * 6144 + n];
    mod[idx] = acc + b_ada[n];
}

__global__ void k_lnmod(const float* x, const float* ctx, const float* mod, float* hmx, float* hmc) {
    __shared__ float red[4];
    const int row = blockIdx.x;
    const float* src; float* dst; int r;
    if (row < M) { src = x + (size_t)row * D; dst = hmx + (size_t)row * D; r = row / L; }
    else { src = ctx + (size_t)(row - M) * D; dst = hmc + (size_t)(row - M) * D; r = 2; }
    float v[8]; float s = 0.f;
#pragma unroll
    for (int j = 0; j < 8; ++j) { v[j] = src[threadIdx.x + 256 * j]; s += v[j]; }
    const float mean = block_sum_256(s, red) * (1.f / D);
    float q = 0.f;
#pragma unroll
    for (int j = 0; j < 8; ++j) { v[j] -= mean; q += v[j] * v[j]; }
    const float rstd = rsqrtf(block_sum_256(q, red) * (1.f / D) + LN_EPS);
    const float* shift = mod + r * 6144; const float* scale = shift + D;
#pragma unroll
    for (int j = 0; j < 8; ++j) { const int col = threadIdx.x + 256 * j; dst[col] = v[j] * rstd * (1.f + scale[col]) + shift[col]; }
}

__global__ void __launch_bounds__(256) k_sgemm(const float* __restrict__ A, int lda, const float* __restrict__ Bm, int ldb, float* __restrict__ C, int ldc, int K) {
    __shared__ float As[8][128 + 4];
    __shared__ float Bs[8][128 + 4];
    const int tid = threadIdx.x, bm = blockIdx.y * 128, bn = blockIdx.x * 128;
    const int tx = tid & 15, ty = tid >> 4;
    float acc[8][8];
#pragma unroll
    for (int i = 0; i < 8; ++i)
#pragma unroll
        for (int j = 0; j < 8; ++j) acc[i][j] = 0.f;
    const int ar = tid >> 1, ac = (tid & 1) * 4;
    const int br = tid >> 5, bc = (tid & 31) * 4;
    for (int k0 = 0; k0 < K; k0 += 8) {
        const float4 av = *(const float4*)(A + (size_t)(bm + ar) * lda + k0 + ac);
        const float4 bv = *(const float4*)(Bm + (size_t)(k0 + br) * ldb + bn + bc);
        __syncthreads();
        As[ac + 0][ar] = av.x; As[ac + 1][ar] = av.y; As[ac + 2][ar] = av.z; As[ac + 3][ar] = av.w;
        *(float4*)&Bs[br][bc] = bv;
        __syncthreads();
#pragma unroll
        for (int kk = 0; kk < 8; ++kk) {
            float a[8], b[8];
#pragma unroll
            for (int i = 0; i < 8; ++i) a[i] = As[kk][ty * 8 + i];
#pragma unroll
            for (int j = 0; j < 8; ++j) b[j] = Bs[kk][tx * 8 + j];
#pragma unroll
            for (int i = 0; i < 8; ++i)
#pragma unroll
                for (int j = 0; j < 8; ++j) acc[i][j] += a[i] * b[j];
        }
    }
#pragma unroll
    for (int i = 0; i < 8; ++i) {
        float* cp = C + (size_t)(bm + ty * 8 + i) * ldc + bn + tx * 8;
        *(float4*)cp = make_float4(acc[i][0], acc[i][1], acc[i][2], acc[i][3]);
        *(float4*)(cp + 4) = make_float4(acc[i][4], acc[i][5], acc[i][6], acc[i][7]);
    }
}

__global__ void k_uvnorm(float* proj, const float* lng, const float* lnb) {
    __shared__ float red[4];
    float* row = proj + (size_t)blockIdx.x * INC;
    float v[4]; float s = 0.f;
#pragma unroll
    for (int j = 0; j < 4; ++j) { const int col = threadIdx.x + 256 * j; row[col] = gelu_f(row[col]); v[j] = gelu_f(row[WA + col]); s += v[j]; }
    const float mean = block_sum_256(s, red) * (1.f / WA);
    float q = 0.f;
#pragma unroll
    for (int j = 0; j < 4; ++j) { v[j] -= mean; q += v[j] * v[j]; }
    const float rstd = rsqrtf(block_sum_256(q, red) * (1.f / WA) + LN_EPS);
#pragma unroll
    for (int j = 0; j < 4; ++j) { const int col = threadIdx.x + 256 * j; row[WA + col] = v[j] * rstd * lng[col] + lnb[col]; }
}

__global__ void __launch_bounds__(256) k_mix(float* proj, const float* ws, const float* bs) {
    __shared__ float vt[128][128];
    const int n = blockIdx.x >> 3, h = blockIdx.x & 7, tid = threadIdx.x;
    const size_t row0 = (size_t)n * 128;
    for (int i = tid; i < 128 * 128; i += 256) { const int q = i >> 7, d = i & 127; vt[q][d] = proj[(row0 + q) * INC + WA + h * 128 + d]; }
    __syncthreads();
    const int d = tid & 127, ph = tid >> 7;
    for (int pp = 0; pp < 64; ++pp) {
        const int p = ph * 64 + pp;
        const float* w = ws + ((size_t)h * 128 + p) * 128;
        float acc = 0.f;
        for (int q = 0; q < 128; ++q) acc += w[q] * vt[q][d];
        acc += bs[h * 128 + p];
        float* rp = proj + (row0 + p) * INC;
        const float u = rp[h * 128 + d], za = rp[2 * WA + h * 128 + d];
        rp[h * 128 + d] = u * acc * silu_f(za);
    }
}

__global__ void __launch_bounds__(64) k_scan(const float* proj, const float* ubc, const float* lam_re, const float* lam_im, const float* log_step,
                                             const float* b_re, const float* b_im, const float* c_re, const float* c_im, float* ydir) {
    __shared__ float s_cre[16][64], s_cim[16][64];
    __shared__ float hs_re[64][65], hs_im[64][65];
    const int d = blockIdx.x >> 7, g = (blockIdx.x >> 1) & 63, b = blockIdx.x & 1, p = threadIdx.x;
    const int dg = d * G + g;
    const float step = expf(log_step[dg]);
    const float lr = lam_re[dg * P + p], li = lam_im[dg * P + p];
    const float dr = lr * step, di = li * step, mag = expf(dr);
    const float are = mag * cosf(di), aim = mag * sinf(di);
    const float den = lr * lr + li * li, nr = are - 1.f, ni = aim;
    const float fre = (nr * lr + ni * li) / den, fim = (ni * lr - nr * li) / den;
    float bbre[16], bbim[16];
#pragma unroll
    for (int c = 0; c < 16; ++c) { const float br = b_re[((size_t)dg * P + p) * 16 + c], bi = b_im[((size_t)dg * P + p) * 16 + c]; bbre[c] = fre * br - fim * bi; bbim[c] = fre * bi + fim * br; }
    for (int c = 0; c < 16; ++c) { s_cre[c][p] = c_re[((size_t)dg * 16 + c) * P + p]; s_cim[c][p] = c_im[((size_t)dg * 16 + c) * P + p]; }
    __syncthreads();
    float hre = 0.f, him = 0.f;
    float* yout = ydir + (size_t)d * M * WB;
    const int nblk = (LC + L) / 64;
#pragma unroll 1
    for (int blk = 0; blk < nblk; ++blk) {
        const bool isctx = blk < LC / 64;
#pragma unroll 1
        for (int s = 0; s < 64; ++s) {
            const int seqpos = (isctx ? blk * 64 : (blk - LC / 64) * 64) + s;
            const float* up;
            if (isctx) { const int t = d == 0 ? seqpos : LC - 1 - seqpos; up = ubc + ((size_t)b * LC + t) * WB + g * 16; }
            else { const int t = d == 0 ? seqpos : L - 1 - seqpos; up = proj + ((size_t)b * L + t) * INC + 3 * WA + g * 16; }
            float bur = 0.f, bui = 0.f;
#pragma unroll
            for (int c = 0; c < 16; ++c) { const float u = up[c]; bur += bbre[c] * u; bui += bbim[c] * u; }
            const float nre = are * hre - aim * him + bur, nim = are * him + aim * hre + bui;
            hre = nre; him = nim;
            hs_re[s][p] = hre; hs_im[s][p] = him;
        }
        __syncthreads();
        if (!isctx) {
            const int s = p; const int seqpos = (blk - LC / 64) * 64 + s; const int t = d == 0 ? seqpos : L - 1 - seqpos;
            float* yp = yout + ((size_t)b * L + t) * WB + g * 16;
#pragma unroll 1
            for (int c = 0; c < 16; ++c) {
                float acc = 0.f;
#pragma unroll 4
                for (int pp = 0; pp < 64; ++pp) acc += s_cre[c][pp] * hs_re[s][pp] - s_cim[c][pp] * hs_im[s][pp];
                yp[c] = acc;
            }
        }
        __syncthreads();
    }
}

__global__ void k_yfinish(float* yf, const float* yb, const float* proj, const float* dskip) {
    const size_t idx = (size_t)blockIdx.x * 256 + threadIdx.x;
    const size_t row = idx / WB; const int col = idx % WB;
    const float u = proj[row * INC + 3 * WA + col];
    yf[idx] = gelu_f(yf[idx] + yb[idx] + dskip[col] * u);
}
__global__ void k_glu(const float* yg, const float* gp, const float* bglu, float* proj) {
    const size_t idx = (size_t)blockIdx.x * 256 + threadIdx.x;
    const size_t row = idx / WB; const int col = idx % WB;
    const float zb = proj[row * INC + 4 * WA + col];
    proj[row * INC + WA + col] = yg[idx] * sigmoid_f(gp[idx] + bglu[col]) * silu_f(zb);
}
__global__ void k_final(const float* x, const float* op, const float* mod, const float* lng, const float* lnb, float* out) {
    __shared__ float red[4];
    const int row = blockIdx.x, r = row / L;
    const float* gate = mod + r * 6144 + 2 * D;
    float v[8]; float s = 0.f;
#pragma unroll
    for (int j = 0; j < 8; ++j) { const int col = threadIdx.x + 256 * j; v[j] = ALPHA * x[(size_t)row * D + col] + gate[col] * op[(size_t)row * D + col]; s += v[j]; }
    const float mean = block_sum_256(s, red) * (1.f / D);
    float q = 0.f;
#pragma unroll
    for (int j = 0; j < 8; ++j) { v[j] -= mean; q += v[j] * v[j]; }
    const float rstd = rsqrtf(block_sum_256(q, red) * (1.f / D) + LN_EPS);
#pragma unroll
    for (int j = 0; j < 8; ++j) { const int col = threadIdx.x + 256 * j; out[(size_t)row * D + col] = v[j] * rstd * lng[col] + lnb[col]; }
}
}

extern "C" void kernel_launch(void* const* d_in, const int* in_sizes, int n_in, void* d_out, int out_size, void* d_ws, size_t ws_size, hipStream_t stream) {
    const float* x = (const float*)d_in[0]; const float* c = (const float*)d_in[1]; const float* ctx = (const float*)d_in[2]; const float* cctx = (const float*)d_in[3];
    const float* w_ada = (const float*)d_in[4]; const float* b_ada = (const float*)d_in[5]; const float* w_in = (const float*)d_in[6];
    const float* sgu_g = (const float*)d_in[7]; const float* sgu_b = (const float*)d_in[8]; const float* w_sp = (const float*)d_in[9]; const float* b_sp = (const float*)d_in[10];
    const float* lam_re = (const float*)d_in[11]; const float* lam_im = (const float*)d_in[12]; const float* log_step = (const float*)d_in[13];
    const float* sb_re = (const float*)d_in[14]; const float* sb_im = (const float*)d_in[15]; const float* sc_re = (const float*)d_in[16]; const float* sc_im = (const float*)d_in[17];
    const float* s5d = (const float*)d_in[18]; const float* w_glu = (const float*)d_in[19]; const float* b_glu = (const float*)d_in[20]; const float* w_out = (const float*)d_in[21];
    const float* ln_g = (const float*)d_in[22]; const float* ln_b = (const float*)d_in[23];
    float* out = (float*)d_out;
    float* ws = (float*)d_ws;
    float* regA = ws;
    float* hmc = regA + (size_t)M * D;
    float* proj = hmc + (size_t)MC * D;
    float* ubc = proj + (size_t)M * INC;
    float* mod = ubc + (size_t)MC * WB;
    float* yf = regA; float* yb = regA + (size_t)M * WB;

    k_mod<<<(3 * 6144 + 255) / 256, 256, 0, stream>>>(c, cctx, w_ada, b_ada, mod);
    k_lnmod<<<M + MC, 256, 0, stream>>>(x, ctx, mod, regA, hmc);
    k_sgemm<<<dim3(INC / 128, M / 128), 256, 0, stream>>>(regA, D, w_in, INC, proj, INC, D);
    k_sgemm<<<dim3(WB / 128, MC / 128), 256, 0, stream>>>(hmc, D, w_in + 3 * WA, INC, ubc, WB, D);
    k_uvnorm<<<M, 256, 0, stream>>>(proj, sgu_g, sgu_b);
    k_mix<<<(M / 128) * NH, 256, 0, stream>>>(proj, w_sp, b_sp);
    k_scan<<<2 * G * NB, 64, 0, stream>>>(proj, ubc, lam_re, lam_im, log_step, sb_re, sb_im, sc_re, sc_im, yf);
    k_yfinish<<<(M * WB) / 256, 256, 0, stream>>>(yf, yb, proj, s5d);
    k_sgemm<<<dim3(WB / 128, M / 128), 256, 0, stream>>>(yf, WB, w_glu, WB, yb, WB, WB);
    k_glu<<<(M * WB) / 256, 256, 0, stream>>>(yf, yb, b_glu, proj);
    k_sgemm<<<dim3(D / 128, M / 128), 256, 0, stream>>>(proj, INC, w_out, D, regA, D, D);
    k_final<<<M, 256, 0, stream>>>(x, regA, mod, ln_g, ln_b, out);
}
```

```cpp
#include <hip/hip_runtime.h>
#include <cstdio>
#include <cstdint>

#define LAS __attribute__((address_space(3)))
#define GAS __attribute__((address_space(1)))
typedef unsigned short bf16_t;
typedef short bf16x8 __attribute__((ext_vector_type(8)));
typedef float f32x4 __attribute__((ext_vector_type(4)));
typedef float f32x2 __attribute__((ext_vector_type(2)));
typedef unsigned u32x4 __attribute__((ext_vector_type(4)));
typedef unsigned u32x2 __attribute__((ext_vector_type(2)));
typedef GAS unsigned gu32;

constexpr int DM = 2048, NB = 2, SEQ = 8192, LCTX = 256, WA = 1024, WB = 1024, NH = 8, NG = 64, NP = 64, INC = 5120;
constexpr int M = NB * SEQ;
constexpr int MC = NB * LCTX;
constexpr int TCH = 32;
constexpr int UXROWS = 16 + 512;
constexpr int UXLD = 768;
constexpr float LN_EPS = 1e-6f;
constexpr float ALPHA = 1.189207115002721f;

constexpr size_t MiB = 1u << 20;
constexpr size_t WS_CTL = 0, CTL_ZERO_BYTES = 1 * MiB;
constexpr size_t WS_MODP = 1 * MiB;
constexpr size_t WS_MODF = WS_MODP + 256 * 1024;
constexpr size_t WS_A32 = WS_MODF + 256 * 1024;
constexpr size_t WS_WSP = 2 * MiB;
constexpr size_t WS_WIN = 3 * MiB;
constexpr size_t WS_WOUT = 23 * MiB;
constexpr size_t WS_WGLU = 31 * MiB;
constexpr size_t WS_OPY = 33 * MiB;
constexpr size_t WS_OPS = 81 * MiB;
constexpr size_t WS_HMOD = 97 * MiB;
constexpr size_t WS_GU = 163 * MiB, WS_GV = 195 * MiB, WS_SZA = 227 * MiB, WS_SZB = 259 * MiB;
constexpr size_t WS_VST = 291 * MiB;
constexpr size_t WS_UX = 293 * MiB;
constexpr size_t WS_Z = 344 * MiB;
constexpr size_t WS_YG = 378 * MiB;
constexpr size_t WS_YCAT = 410 * MiB;
constexpr size_t WS_END = 474 * MiB;
static_assert(WS_UX + (size_t)(64 * UXROWS + 240) * UXLD * 2 <= WS_Z, "UX");
static_assert(WS_Z + (size_t)64 * UXROWS * 256 * 4 <= WS_YG, "Z");

constexpr int CW_BAR = 4096;
constexpr int RING_BYTES = 131072, MISC_OFF = RING_BYTES + 320, LDS_BYTES = 147456;
constexpr int NWAVES = 8;

__device__ __forceinline__ unsigned cvt_pk_bf16(float lo, float hi) { unsigned r; asm volatile("v_cvt_pk_bf16_f32 %0, %1, %2" : "=v"(r) : "v"(lo), "v"(hi)); return r; }
__device__ __forceinline__ unsigned f2bf(float f) { unsigned u = __builtin_bit_cast(unsigned, f); return (u + 0x7fffu + ((u >> 16) & 1u)) >> 16; }
__device__ __forceinline__ unsigned pk2(float lo, float hi) { return f2bf(lo) | (f2bf(hi) << 16); }
__device__ __forceinline__ float bflo(unsigned w) { return __builtin_bit_cast(float, w << 16); }
__device__ __forceinline__ float bfhi(unsigned w) { return __builtin_bit_cast(float, w & 0xffff0000u); }
__device__ __forceinline__ float silu_f(float v) { return v * __builtin_amdgcn_rcpf(1.f + __builtin_amdgcn_exp2f(-1.4426950408889634f * v)); }
__device__ __forceinline__ float sigmoid_f(float v) { return __builtin_amdgcn_rcpf(1.f + __builtin_amdgcn_exp2f(-1.4426950408889634f * v)); }
__device__ __forceinline__ f32x2 gelu_pk(f32x2 v) {
    const f32x2 av = __builtin_elementwise_abs(v), d = av * 0.2316418882f + 1.0f;
    f32x2 t; t.x = __builtin_amdgcn_rcpf(d.x); t.y = __builtin_amdgcn_rcpf(d.y);
    f32x2 q = t * 0.5307027145f + (-0.7265760135f); q = q * t + 0.7107068705f; q = q * t + (-0.142248368f); q = q * t + 0.127414796f; q = q * t;
    const f32x2 s = (v * v) * (-0.72134752044f);
    f32x2 e; e.x = __builtin_amdgcn_exp2f(s.x); e.y = __builtin_amdgcn_exp2f(s.y);
    const f32x2 m = v * (q * e), r = v - m;
    f32x2 o; o.x = v.x < 0.f ? m.x : r.x; o.y = v.y < 0.f ? m.y : r.y; return o;
}
__device__ __forceinline__ f32x4 gelu4(f32x4 v) { const f32x2 a = gelu_pk((f32x2){v[0], v[1]}), b = gelu_pk((f32x2){v[2], v[3]}); return (f32x4){a.x, a.y, b.x, b.y}; }
__device__ __forceinline__ f32x4 silu4(f32x4 v) { return (f32x4){silu_f(v[0]), silu_f(v[1]), silu_f(v[2]), silu_f(v[3])}; }
__device__ __forceinline__ float wave_sum(float v) {
#pragma unroll
    for (int o = 1; o < 64; o <<= 1) v += __shfl_xor(v, o);
    return v;
}
#define LDS_WAIT() asm volatile("s_waitcnt lgkmcnt(0)" ::: "memory")
#define VM_WAIT() asm volatile("s_waitcnt vmcnt(0)" ::: "memory")

namespace pg8 {
constexpr int BM = 256, BK = 64, HALF = 128, HTB = HALF * BK * 2, STAGE_BYTES = 8 * HTB, NXCD = 8, WGM = 8;
__host__ __device__ __forceinline__ int lds_byte(int r, int c) { const int st = (r >> 4) * 2 + (c >> 5), rr = r & 15, cc = c & 31, ob = rr * 64 + cc * 2; return st * 1024 + (ob ^ (((ob >> 9) & 1) << 5)); }
__host__ __device__ __forceinline__ void stage_rc(int b, int& R, int& C) { const int st = b / 1024, sb = b % 1024, swz = sb ^ (((sb >> 9) & 1) << 5); R = (st >> 1) * 16 + swz / 64; C = (st & 1) * 32 + (swz % 64) / 2; }
__host__ __device__ __forceinline__ int perm32(int rho) { const int n = rho >> 4, i = rho & 15; return 8 * (i >> 2) + 4 * n + (i & 3); }

struct Unit { const char* pA; const char* pB; int pm, pn, g; };
struct Geom { int nt; unsigned ldaB, ldbB; size_t kstepA, kstepB; unsigned gstrideB; };

struct StaticOrder {
    int nM, nN, nwg, G, c;
    __device__ void init(int nM_, int nN_, int G_, int c_) { nM = nM_; nN = nN_; nwg = nM * nN; G = G_; c = c_; }
    __device__ bool tile(int i, int& pm, int& pn) const {
        const long L = (long)i * G + c; if (L >= nwg) return false;
        int wgid = (int)L; { const int q = nwg / NXCD, r = nwg % NXCD, xcd = wgid % NXCD, off = wgid / NXCD; wgid = (xcd < r ? xcd * (q + 1) : r * (q + 1) + (xcd - r) * q) + off; }
        const int nig = WGM * nN, gid = wgid / nig, fm = gid * WGM, gsz = (nM - fm) < WGM ? (nM - fm) : WGM;
        pm = fm + ((wgid % nig) % gsz); pn = (wgid % nig) / gsz; return true;
    }
};

template <class Epi, class Sched, int AMODE, bool ALIGN_EPI, bool SP2>
__device__ __forceinline__ void gemm_phase(LAS unsigned char* lds, const Geom g, const Sched& S, const Epi& E) {
    const int tid = threadIdx.x, wid = __builtin_amdgcn_readfirstlane(tid >> 6), lane = tid & 63, wr = wid >> 2, wc = wid & 3, fr = lane & 15, fq = lane >> 4;
    const int nt = g.nt;
    unsigned voffA[2], voffB[2];
#pragma unroll
    for (int i = 0; i < 2; ++i) { int R, C; stage_rc(tid * 16 + i * 8192, R, C); const int Rb = Epi::PERM ? ((R & ~31) + perm32(R & 31)) : R;
        voffA[i] = AMODE == 0 ? (unsigned)R * g.ldaB + (unsigned)C * 2u : (unsigned)(C >> 4) * g.gstrideB + (unsigned)R * 32u + (unsigned)(C & 15) * 2u;
        voffB[i] = (unsigned)Rb * g.ldbB + (unsigned)C * 2u; }
    const size_t kstepA = g.kstepA, kstepB = g.kstepB;
    const size_t hstepA = (size_t)HALF * (AMODE == 0 ? g.ldaB : 32u), hstepB = (size_t)HALF * g.ldbB;
    const unsigned ldsw = (unsigned)wid * 1024u;
    const int aoff = lds_byte(wr * 64 + fr, fq * 8), boff = lds_byte(wc * 32 + fr, fq * 8);
#define PG8_SA(b, h) (((b) * 2 + (h)) * HTB)
#define PG8_SB(b, h) ((4 + (b) * 2 + (h)) * HTB)
#define PG8_STAGE(bufoff, gbase, voff) do { _Pragma("unroll") for (int _i = 0; _i < 2; ++_i) \
        __builtin_amdgcn_global_load_lds((const unsigned*)((const char*)(gbase) + (voff)[_i]), (LAS unsigned*)(lds + (bufoff) + ldsw + _i * 8192), 16, 0, 0); } while (0)
#define PG8_LDA(dst, b, h) do { _Pragma("unroll") for (int m = 0; m < 4; ++m) _Pragma("unroll") for (int k = 0; k < 2; ++k) dst[m][k] = *(const LAS bf16x8*)(lds + PG8_SA(b, h) + aoff + m * 2048 + k * 1024); } while (0)
#define PG8_LDB(dst, b, h) do { _Pragma("unroll") for (int n = 0; n < 2; ++n) _Pragma("unroll") for (int k = 0; k < 2; ++k) dst[n][k] = *(const LAS bf16x8*)(lds + PG8_SB(b, h) + boff + n * 2048 + k * 1024); } while (0)
#define PG8_MMA(ai, bj, At, Bt) do { __builtin_amdgcn_s_setprio(1); _Pragma("unroll") for (int m = 0; m < 4; ++m) _Pragma("unroll") for (int n = 0; n < 2; ++n) _Pragma("unroll") for (int k = 0; k < 2; ++k) \
        acc[ai][bj][m][n] = __builtin_amdgcn_mfma_f32_16x16x32_bf16(Bt[n][k], At[m][k], acc[ai][bj][m][n], 0, 0, 0); __builtin_amdgcn_s_setprio(0); } while (0)
#define PG8_WAIT_V(n) asm volatile("s_waitcnt vmcnt(" #n ")" ::: "memory")
#define PG8_WAIT_L(n) asm volatile("s_waitcnt lgkmcnt(" #n ")" ::: "memory")
#define PG8_BAR __builtin_amdgcn_s_barrier()
#define PG8_SCHED __builtin_amdgcn_sched_barrier(0)
    Unit cur, nxt; int ui = 0;
    if (!S.next(0, cur)) return;
    f32x4 acc[2][2][4][2];
#pragma unroll
    for (int a = 0; a < 2; ++a)
#pragma unroll
        for (int b = 0; b < 2; ++b)
#pragma unroll
            for (int m = 0; m < 4; ++m)
#pragma unroll
                for (int n = 0; n < 2; ++n) acc[a][b][m][n] = (f32x4){0.f, 0.f, 0.f, 0.f};
    bf16x8 At[4][2], B0[2][2], B1[2][2];
    const char* cA = cur.pA; const char* cB = cur.pB;
    if constexpr (SP2) {
        PG8_STAGE(PG8_SB(0, 0), cB, voffB); PG8_STAGE(PG8_SB(0, 1), cB + hstepB, voffB); PG8_STAGE(PG8_SA(0, 0), cA, voffA); PG8_STAGE(PG8_SA(0, 1), cA + hstepA, voffA);
        if (wr == 1) PG8_BAR;
        PG8_WAIT_V(2); PG8_BAR;
        PG8_STAGE(PG8_SB(1, 0), cB + kstepB, voffB); PG8_STAGE(PG8_SA(1, 0), cA + kstepA, voffA); PG8_STAGE(PG8_SB(1, 1), cB + hstepB + kstepB, voffB);
        PG8_WAIT_V(6); PG8_BAR;
    } else {
        PG8_STAGE(PG8_SB(0, 0), cB, voffB); PG8_STAGE(PG8_SA(0, 0), cA, voffA); PG8_STAGE(PG8_SB(0, 1), cB + hstepB, voffB); PG8_STAGE(PG8_SA(0, 1), cA + hstepA, voffA);
        if (wr == 1) PG8_BAR;
        PG8_WAIT_V(4); PG8_BAR;
        PG8_STAGE(PG8_SB(1, 0), cB + kstepB, voffB); PG8_STAGE(PG8_SA(1, 0), cA + kstepA, voffA); PG8_STAGE(PG8_SB(1, 1), cB + hstepB + kstepB, voffB);
        PG8_WAIT_V(6); PG8_BAR;
    }
    for (;;) {
        const bool has_next = S.next(ui + 1, nxt);
        const char* nA = has_next ? nxt.pA : cA; const char* nB = has_next ? nxt.pB : cB;
        for (int t = 0; t < nt; t += 2) {
            const bool last = (t == nt - 2);
            const char* a1 = cA + (size_t)(t + 1) * kstepA;
            const char* a2 = last ? nA : cA + (size_t)(t + 2) * kstepA; const char* b2 = last ? nB : cB + (size_t)(t + 2) * kstepB;
            const char* a3 = a2 + kstepA; const char* b3 = b2 + kstepB;
            if constexpr (SP2) {
            PG8_LDB(B0, 0, 0); PG8_LDB(B1, 0, 1); PG8_SCHED; PG8_LDA(At, 0, 0); PG8_STAGE(PG8_SA(1, 1), a1 + hstepA, voffA);
            PG8_WAIT_V(8); PG8_WAIT_L(0); PG8_BAR; PG8_MMA(0, 0, At, B0); PG8_MMA(0, 1, At, B1); PG8_BAR; PG8_SCHED;
            PG8_LDA(At, 0, 1); PG8_STAGE(PG8_SB(0, 0), b2, voffB); PG8_STAGE(PG8_SB(0, 1), b2 + hstepB, voffB); PG8_STAGE(PG8_SA(0, 0), a2, voffA);
            PG8_WAIT_V(8); PG8_WAIT_L(0); PG8_BAR; PG8_MMA(1, 0, At, B0); PG8_MMA(1, 1, At, B1); PG8_BAR; PG8_SCHED;
            PG8_LDB(B0, 1, 0); PG8_LDB(B1, 1, 1); PG8_SCHED; PG8_LDA(At, 1, 0); PG8_STAGE(PG8_SA(0, 1), a2 + hstepA, voffA);
            PG8_WAIT_V(8); PG8_WAIT_L(0); PG8_BAR; PG8_MMA(0, 0, At, B0); PG8_MMA(0, 1, At, B1); PG8_BAR; PG8_SCHED;
            PG8_LDA(At, 1, 1); PG8_STAGE(PG8_SB(1, 0), b3, voffB); PG8_STAGE(PG8_SB(1, 1), b3 + hstepB, voffB); PG8_STAGE(PG8_SA(1, 0), a3, voffA);
            PG8_WAIT_V(8); PG8_WAIT_L(0); PG8_BAR; PG8_MMA(1, 0, At, B0); PG8_MMA(1, 1, At, B1); PG8_BAR; PG8_SCHED;
            } else {
            PG8_LDB(B0, 0, 0); PG8_SCHED; PG8_LDA(At, 0, 0); PG8_STAGE(PG8_SA(1, 1), a1 + hstepA, voffA);
            PG8_WAIT_L(8); PG8_BAR; PG8_WAIT_L(0); PG8_MMA(0, 0, At, B0); PG8_BAR; PG8_SCHED;
            PG8_LDB(B1, 0, 1); PG8_STAGE(PG8_SB(0, 0), b2, voffB);
            PG8_BAR; PG8_WAIT_L(0); PG8_MMA(0, 1, At, B1); PG8_BAR;
            PG8_LDA(At, 0, 1); PG8_STAGE(PG8_SA(0, 0), a2, voffA);
            PG8_BAR; PG8_WAIT_L(0); PG8_MMA(1, 0, At, B0); PG8_BAR; PG8_SCHED;
            PG8_STAGE(PG8_SB(0, 1), b2 + hstepB, voffB);
            PG8_WAIT_V(6); PG8_BAR; PG8_MMA(1, 1, At, B1); PG8_BAR;
            PG8_LDB(B0, 1, 0); PG8_SCHED; PG8_LDA(At, 1, 0); PG8_STAGE(PG8_SA(0, 1), a2 + hstepA, voffA);
            PG8_WAIT_L(8); PG8_BAR; PG8_WAIT_L(0); PG8_MMA(0, 0, At, B0); PG8_BAR; PG8_SCHED;
            PG8_LDB(B1, 1, 1); PG8_STAGE(PG8_SB(1, 0), b3, voffB);
            PG8_BAR; PG8_WAIT_L(0); PG8_MMA(0, 1, At, B1); PG8_BAR;
            PG8_LDA(At, 1, 1); PG8_STAGE(PG8_SA(1, 0), a3, voffA);
            PG8_BAR; PG8_WAIT_L(0); PG8_MMA(1, 0, At, B0); PG8_BAR; PG8_SCHED;
            PG8_STAGE(PG8_SB(1, 1), b3 + hstepB, voffB);
            PG8_WAIT_V(6); PG8_BAR; PG8_MMA(1, 1, At, B1); PG8_BAR;
            }
        }
        if constexpr (ALIGN_EPI) { if (wr == 0) PG8_BAR; }
        E(acc, cur, wr, wc, fr, fq);
        if (!has_next) break;
#pragma unroll
        for (int a = 0; a < 2; ++a)
#pragma unroll
            for (int b = 0; b < 2; ++b)
#pragma unroll
                for (int m = 0; m < 4; ++m)
#pragma unroll
                    for (int n = 0; n < 2; ++n) acc[a][b][m][n] = (f32x4){0.f, 0.f, 0.f, 0.f};
        cur = nxt; cA = nA; cB = nB; ++ui;
        if constexpr (ALIGN_EPI) { if (wr == 1) PG8_BAR; }
    }
    PG8_WAIT_V(0);
    if constexpr (!ALIGN_EPI) { if (wr == 0) PG8_BAR; }
    PG8_BAR;
#undef PG8_SA
#undef PG8_SB
#undef PG8_STAGE
#undef PG8_LDA
#undef PG8_LDB
#undef PG8_MMA
#undef PG8_WAIT_V
#undef PG8_WAIT_L
#undef PG8_BAR
#undef PG8_SCHED
}
}
using pg8::Unit;

struct Epi1 {
    static constexpr bool PERM = true;
    bf16_t *GU, *GV, *SZA, *SZB, *UX; float* VST;
    __device__ __forceinline__ void operator()(const f32x4 (&acc)[2][2][4][2], const Unit& u, int wr, int wc, int fr, int fq) const {
        const int type = u.pn >> 2, pq = u.pn & 3;
        const int rowb = u.pm * 256 + wr * 64 + fr;
        if (type == 3) {
#pragma unroll
            for (int ai = 0; ai < 2; ++ai)
#pragma unroll
                for (int m = 0; m < 4; ++m) {
                    const int row = rowb + ai * 128 + m * 16;
                    const int chunkrow = row < M ? 16 + (row >> 5) : ((row - M) >> 5), j = row & 31;
#pragma unroll
                    for (int bj = 0; bj < 2; ++bj) {
                        const int g = pq * 16 + bj * 8 + wc * 2 + (fq >> 1);
                        bf16_t* p = UX + ((size_t)g * UXROWS + chunkrow) * UXLD + j * 16 + (fq & 1) * 8;
                        const f32x4 v0 = acc[ai][bj][m][0], v1 = acc[ai][bj][m][1];
                        u32x4 w; w.x = cvt_pk_bf16(v0[0], v0[1]); w.y = cvt_pk_bf16(v0[2], v0[3]); w.z = cvt_pk_bf16(v1[0], v1[1]); w.w = cvt_pk_bf16(v1[2], v1[3]);
                        *(u32x4*)p = w;
                    }
                }
            return;
        }
        bf16_t* base = type == 0 ? GU : (type == 1 ? GV : (type == 2 ? SZA : SZB));
        const int colt = pq * 256 + wc * 32 + 8 * fq;
#pragma unroll
        for (int ai = 0; ai < 2; ++ai)
#pragma unroll
            for (int m = 0; m < 4; ++m) {
                const int row = rowb + ai * 128 + m * 16;
                bf16_t* rowp = base + (size_t)row * 1024 + colt;
                float s = 0.f, q = 0.f;
#pragma unroll
                for (int bj = 0; bj < 2; ++bj) {
                    f32x4 v0 = acc[ai][bj][m][0], v1 = acc[ai][bj][m][1];
                    if (type <= 1) { v0 = gelu4(v0); v1 = gelu4(v1); } else { v0 = silu4(v0); v1 = silu4(v1); }
                    if (type == 1) { s += (v0[0] + v0[1]) + (v0[2] + v0[3]) + (v1[0] + v1[1]) + (v1[2] + v1[3]);
                        q += (v0[0] * v0[0] + v0[1] * v0[1]) + (v0[2] * v0[2] + v0[3] * v0[3]) + (v1[0] * v1[0] + v1[1] * v1[1]) + (v1[2] * v1[2] + v1[3] * v1[3]); }
                    u32x4 w; w.x = cvt_pk_bf16(v0[0], v0[1]); w.y = cvt_pk_bf16(v0[2], v0[3]); w.z = cvt_pk_bf16(v1[0], v1[1]); w.w = cvt_pk_bf16(v1[2], v1[3]);
                    *(u32x4*)(rowp + bj * 128) = w;
                }
                if (type == 1) {
                    s += __shfl_xor(s, 16); s += __shfl_xor(s, 32); q += __shfl_xor(q, 16); q += __shfl_xor(q, 32);
                    if (fq == 0) *(f32x2*)(VST + ((size_t)row * 16 + pq * 4 + wc) * 2) = (f32x2){s, q};
                }
            }
    }
};
struct EpiZ {
    static constexpr bool PERM = false;
    float* Z;
    __device__ __forceinline__ void operator()(const f32x4 (&acc)[2][2][4][2], const Unit& u, int wr, int wc, int fr, int fq) const {
#pragma unroll
        for (int ai = 0; ai < 2; ++ai)
#pragma unroll
            for (int m = 0; m < 4; ++m) {
                const int row = u.pm * 256 + ai * 128 + wr * 64 + m * 16 + fr;
                if (row < UXROWS) { float* rp = Z + ((size_t)u.g * UXROWS + row) * 256 + wc * 32 + 4 * fq;
#pragma unroll
                    for (int bj = 0; bj < 2; ++bj)
#pragma unroll
                        for (int n = 0; n < 2; ++n) *(f32x4*)(rp + bj * 128 + n * 16) = acc[ai][bj][m][n]; }
            }
    }
};
struct EpiY {
    static constexpr bool PERM = true;
    bf16_t* YG;
    __device__ __forceinline__ void operator()(const f32x4 (&acc)[2][2][4][2], const Unit& u, int wr, int wc, int fr, int fq) const {
        bf16_t* base = YG + (size_t)u.g * M * 16 + (size_t)(u.pm * 256 + wr * 64 + fr) * 512 + u.pn * 256 + wc * 32 + 8 * fq;
#pragma unroll
        for (int ai = 0; ai < 2; ++ai)
#pragma unroll
            for (int m = 0; m < 4; ++m)
#pragma unroll
                for (int bj = 0; bj < 2; ++bj) {
                    const f32x4 v0 = gelu4(acc[ai][bj][m][0]), v1 = gelu4(acc[ai][bj][m][1]);
                    u32x4 w; w.x = cvt_pk_bf16(v0[0], v0[1]); w.y = cvt_pk_bf16(v0[2], v0[3]); w.z = cvt_pk_bf16(v1[0], v1[1]); w.w = cvt_pk_bf16(v1[2], v1[3]);
                    *(u32x4*)(base + (size_t)(ai * 128 + m * 16) * 512 + bj * 128) = w;
                }
    }
};
struct EpiG {
    static constexpr bool PERM = true;
    const bf16_t* YG; const bf16_t* SZB; const float* bglu; bf16_t* YCAT;
    __device__ __forceinline__ void operator()(const f32x4 (&acc)[2][2][4][2], const Unit& u, int wr, int wc, int fr, int fq) const {
        const int rowb = u.pm * 256 + wr * 64 + fr, colb = u.pn * 256 + wc * 32 + 8 * fq;
#pragma unroll
        for (int bj = 0; bj < 2; ++bj) {
            const int col = colb + bj * 128;
            const f32x4 b0 = *(const f32x4*)(bglu + col), b1 = *(const f32x4*)(bglu + col + 4);
#pragma unroll
            for (int ai = 0; ai < 2; ++ai)
#pragma unroll
                for (int m = 0; m < 4; ++m) {
                    const int row = rowb + ai * 128 + m * 16;
                    const u32x4 yv = *(const u32x4*)(YG + ((size_t)(col >> 4) * M + row) * 16 + (col & 15));
                    const u32x4 zv = *(const u32x4*)(SZB + (size_t)row * 1024 + col);
                    const f32x4 a0 = acc[ai][bj][m][0] + b0, a1 = acc[ai][bj][m][1] + b1;
                    u32x4 w;
                    w.x = cvt_pk_bf16(bflo(yv.x) * sigmoid_f(a0[0]) * bflo(zv.x), bfhi(yv.x) * sigmoid_f(a0[1]) * bfhi(zv.x));
                    w.y = cvt_pk_bf16(bflo(yv.y) * sigmoid_f(a0[2]) * bflo(zv.y), bfhi(yv.y) * sigmoid_f(a0[3]) * bfhi(zv.y));
                    w.z = cvt_pk_bf16(bflo(yv.z) * sigmoid_f(a1[0]) * bflo(zv.z), bfhi(yv.z) * sigmoid_f(a1[1]) * bfhi(zv.z));
                    w.w = cvt_pk_bf16(bflo(yv.w) * sigmoid_f(a1[2]) * bflo(zv.w), bfhi(yv.w) * sigmoid_f(a1[3]) * bfhi(zv.w));
                    *(u32x4*)(YCAT + (size_t)row * 2048 + 1024 + col) = w;
                }
        }
    }
};
struct EpiO {
    static constexpr bool PERM = false;
    const float* x; const float* modf; float* out;
    __device__ __forceinline__ void operator()(const f32x4 (&acc)[2][2][4][2], const Unit& u, int wr, int wc, int fr, int fq) const {
        const int rowb = u.pm * 256 + wr * 64 + fr, colb = u.pn * 256 + wc * 32 + 4 * fq;
        const float* gate = modf + (u.pm >= 32 ? 6144 : 0) + 2 * DM;
#pragma unroll
        for (int bj = 0; bj < 2; ++bj)
#pragma unroll
            for (int n = 0; n < 2; ++n) {
                const int col = colb + bj * 128 + n * 16;
                const f32x4 gt = *(const f32x4*)(gate + col);
#pragma unroll
                for (int ai = 0; ai < 2; ++ai)
#pragma unroll
                    for (int m = 0; m < 4; ++m) {
                        const size_t off = (size_t)(rowb + ai * 128 + m * 16) * DM + col;
                        const f32x4 xv = *(const f32x4*)(x + off);
                        *(f32x4*)(out + off) = xv * ALPHA + gt * acc[ai][bj][m][n];
                    }
            }
    }
};

struct Sched1 {
    pg8::StaticOrder so; const char* A; const char* Bt;
    __device__ bool next(int i, Unit& u) const {
        int pm, pn;
        if (!so.tile(i, pm, pn)) { const long L = (long)i * so.G + so.c - so.nwg; if (L < 0 || L >= 8) return false; pm = 64 + (int)(L >> 2); pn = 12 + (int)(L & 3); }
        u.pm = pm; u.pn = pn; u.g = 0; u.pA = A + (size_t)pm * 256 * DM * 2; u.pB = Bt + (size_t)pn * 256 * DM * 2; return true;
    }
};
struct SchedZ {
    const char* UX; const char* OPS; int c;
    __device__ bool next(int i, Unit& u) const {
        if (i > 0 || (c >> 3) >= 24) return false;
        const int L = (c & 7) * 24 + (c >> 3); u.g = L / 3; u.pm = L % 3; u.pn = 0;
        u.pA = UX + ((size_t)u.g * UXROWS + u.pm * 256) * UXLD * 2; u.pB = OPS + (size_t)u.g * 256 * 512 * 2; return true;
    }
};
struct SchedY {
    const char* UX; const char* OPY; int c;
    __device__ bool next(int i, Unit& u) const {
        if (i > 0) return false;
        const int L = (c & 7) * 32 + (c >> 3); u.g = L >> 2; u.pm = (L >> 1) & 1; u.pn = L & 1;
        u.pA = UX + ((size_t)u.g * UXROWS + 16 + u.pm * 256) * UXLD * 2; u.pB = OPY + ((size_t)u.g * 512 + u.pn * 256) * UXLD * 2; return true;
    }
};
struct SchedG {
    pg8::StaticOrder so; const char* YG; const char* Bt;
    __device__ bool next(int i, Unit& u) const {
        int pm, pn; if (!so.tile(i, pm, pn)) return false;
        u.pm = pm; u.pn = pn; u.g = 0; u.pA = YG + (size_t)pm * 256 * 32; u.pB = Bt + (size_t)pn * 256 * WB * 2; return true;
    }
};
struct SchedO {
    pg8::StaticOrder so; const char* A; const char* Bt;
    __device__ bool next(int i, Unit& u) const {
        int pm, pn; if (!so.tile(i, pm, pn)) return false;
        u.pm = pm; u.pn = pn; u.g = 0; u.pA = A + (size_t)pm * 256 * DM * 2; u.pB = Bt + (size_t)pn * 256 * DM * 2; return true;
    }
};

#define XB_TMO      128
#define XB_XCNT(j)  (256  + 64 * (j))
#define XB_XSUB(j)  (1280 + 64 * (j))
#define XB_XGEN(j)  (2304 + 64 * (j))
#define XB_TOP      3328
#define XB_TOPGEN   3392
#define XCD_BAR_WORDS 3456
#define XB_SPIN_CAP (1u << 18)
__device__ __forceinline__ unsigned xb_ld(unsigned* p)              { return __hip_atomic_load(p, __ATOMIC_RELAXED, __HIP_MEMORY_SCOPE_AGENT); }
__device__ __forceinline__ unsigned xb_add(unsigned* p, unsigned v) { return __hip_atomic_fetch_add(p, v, __ATOMIC_RELAXED, __HIP_MEMORY_SCOPE_AGENT); }
__device__ __forceinline__ unsigned xb_xcc_id() { return (unsigned)__builtin_amdgcn_s_getreg((3 << 11) | 20) & 0xFu; }
#define XB_SPIN(cond, bar) do { unsigned _sp = 0; while (cond) { __builtin_amdgcn_s_sleep(1); \
    if ((++_sp & 255u) == 0u) { if (xb_ld(&(bar)[XB_TMO])) break; if (_sp > XB_SPIN_CAP) { atomicAdd(&(bar)[XB_TMO], 1u); break; } } } } while (0)
struct XcdBarrier { unsigned* bar; unsigned x; volatile LAS unsigned* st; };
__device__ __forceinline__ XcdBarrier xcd_barrier_post(unsigned* bar, volatile LAS unsigned* st) {
    XcdBarrier b; b.bar = bar; b.x = xb_xcc_id(); b.st = st;
    if (threadIdx.x == 0) (void)xb_add(&bar[XB_XCNT(b.x)], 1u);
    return b;
}
__device__ __forceinline__ void xcd_barrier_complete(unsigned* bar, unsigned x, unsigned& nloc, unsigned& nx) {
    const unsigned G = gridDim.x * gridDim.y * gridDim.z;
    unsigned sum, cnt, mine, sp = 0u;
    for (;;) {
        sum = 0u; cnt = 0u; mine = 0u;
#pragma unroll
        for (unsigned j = 0; j < 16; ++j) { const unsigned c = xb_ld(&bar[XB_XCNT(j)]); sum += c; cnt += (c > 0u) ? 1u : 0u; mine = (j == x) ? c : mine; }
        if (sum == G) break;
        __builtin_amdgcn_s_sleep(1);
        if ((++sp & 255u) == 0u) { if (xb_ld(&bar[XB_TMO])) break; if (sp > XB_SPIN_CAP) { atomicAdd(&bar[XB_TMO], 1u); break; } }
    }
    nloc = mine > 0u ? mine : 1u; nx = cnt > 0u ? cnt : 1u;
}
__device__ __forceinline__ void xcd_barrier(const XcdBarrier& b) {
    asm volatile("s_waitcnt vmcnt(0)" ::: "memory");
    __syncthreads();
    if (threadIdx.x == 0) {
        unsigned* bar = b.bar;
        __builtin_amdgcn_s_waitcnt(0);
        unsigned nloc = b.st[0], nx = b.st[1];
        if (nloc == 0u) { xcd_barrier_complete(bar, b.x, nloc, nx); b.st[0] = nloc; b.st[1] = nx; }
        const unsigned old = xb_add(&bar[XB_XSUB(b.x)], 1u);
        const unsigned gen = old / nloc;
        if (old + 1u == (gen + 1u) * nloc) {
            __builtin_amdgcn_fence(__ATOMIC_RELEASE, "agent");
            asm volatile("s_waitcnt vmcnt(0)" ::: "memory");
            const unsigned og = xb_add(&bar[XB_TOP], 1u);
            const unsigned tg = og / nx;
            if (og + 1u == (tg + 1u) * nx) xb_add(&bar[XB_TOPGEN], 1u);
            else XB_SPIN(xb_ld(&bar[XB_TOPGEN]) == tg, bar);
            __builtin_amdgcn_fence(__ATOMIC_ACQUIRE, "agent");
            xb_add(&bar[XB_XGEN(b.x)], 1u);
            asm volatile("s_waitcnt vmcnt(0)" ::: "memory");
        } else {
            XB_SPIN(xb_ld(&bar[XB_XGEN(b.x)]) == gen, bar);
            __builtin_amdgcn_fence(__ATOMIC_ACQUIRE, "agent");
            asm volatile("s_waitcnt vmcnt(0)" ::: "memory");
        }
    }
    __syncthreads();
}

struct Args { const float* in[24]; float* out; unsigned char* ws; };

__device__ __forceinline__ void p0_transpose_item(const float* W, int K, int N, bf16_t* WT, LAS float* scr, int item, int lane) {
    const int nblk = N / 32, kb = item / nblk, nb = item % nblk, k0 = 64 * kb, n0 = 32 * nb;
#pragma unroll 8
    for (int i = 0; i < 32; ++i) { const int kk = 2 * i + (lane >> 5); scr[kk * 33 + (lane & 31)] = W[(size_t)(k0 + kk) * N + n0 + (lane & 31)]; }
    LDS_WAIT(); asm volatile("" ::: "memory");
    const int c = lane & 7;
#pragma unroll
    for (int j = 0; j < 4; ++j) { const int n = (lane >> 3) + 8 * j; const LAS float* s = scr + (8 * c) * 33 + n;
        u32x4 o; o.x = pk2(s[0 * 33], s[1 * 33]); o.y = pk2(s[2 * 33], s[3 * 33]); o.z = pk2(s[4 * 33], s[5 * 33]); o.w = pk2(s[6 * 33], s[7 * 33]);
        *(u32x4*)(WT + (size_t)(n0 + n) * K + k0 + 8 * c) = o; }
    LDS_WAIT(); asm volatile("" ::: "memory");
}

__device__ __forceinline__ void p0_s5_item(const Args& a, LAS unsigned char* lds, int g, int qq, int tid) {
    const float* lam_re = a.in[11]; const float* lam_im = a.in[12]; const float* log_step = a.in[13];
    const float* b_re = a.in[14]; const float* b_im = a.in[15]; const float* c_re = a.in[16]; const float* c_im = a.in[17]; const float* dsk = a.in[18];
    bf16_t* OPY = (bf16_t*)(a.ws + WS_OPY); bf16_t* OPS = (bf16_t*)(a.ws + WS_OPS); float* A32 = (float*)(a.ws + WS_A32);
    LAS float* sBr = (LAS float*)lds;
    LAS float* sBi = sBr + 2048;
    LAS float* sCr = sBi + 2048;
    LAS float* sCi = sCr + 2048;
    LAS float* sPr = sCi + 2048;
    LAS float* sPi = sPr + 4224;
    LAS float* sCAr = sPi + 4224;
    LAS float* sCAi = sCAr + 2048;
    LAS float* sK = sCAi + 2048;
    if (tid < 128) {
        const int d = tid >> 6, p = tid & 63, dg = d * NG + g;
        const float step = expf(log_step[dg]);
        const float lr = lam_re[dg * NP + p], li = lam_im[dg * NP + p];
        const float dr = lr * step, di = li * step;
        for (int e = 0; e <= 32; ++e) { const float mg = expf(dr * (float)e); float sn, cs; sincosf(di * (float)e, &sn, &cs); sPr[(d * 33 + e) * 64 + p] = mg * cs; sPi[(d * 33 + e) * 64 + p] = mg * sn; }
        const float mag = expf(dr), are = mag * cosf(di), aim = mag * sinf(di);
        const float den = lr * lr + li * li, nr = are - 1.f, ni = aim;
        const float fre = (nr * lr + ni * li) / den, fim = (ni * lr - nr * li) / den;
        for (int c = 0; c < 16; ++c) { const float br = b_re[((size_t)dg * NP + p) * 16 + c], bi = b_im[((size_t)dg * NP + p) * 16 + c];
            sBr[(d * 64 + p) * 16 + c] = fre * br - fim * bi; sBi[(d * 64 + p) * 16 + c] = fre * bi + fim * br; }
        if (qq == 0) { const float mg = expf(dr * 32.f); float sn, cs; sincosf(di * 32.f, &sn, &cs); A32[((g * 2 + d) * 2 + 0) * 64 + p] = mg * cs; A32[((g * 2 + d) * 2 + 1) * 64 + p] = mg * sn; }
    }
    for (int i = tid; i < 2048; i += 512) { const int d = i >> 10, r = i & 1023; sCr[i] = c_re[(size_t)(d * NG + g) * 1024 + r]; sCi[i] = c_im[(size_t)(d * NG + g) * 1024 + r]; }
    __syncthreads();
    for (int ll = 0; ll < 8; ++ll) {
        const int l = 8 * qq + ll;
        for (int i = tid; i < 2048; i += 512) { const int d = i >> 10, p = i & 63; const float cr = sCr[i], ci = sCi[i], pr = sPr[(d * 33 + l) * 64 + p], pi = sPi[(d * 33 + l) * 64 + p];
            sCAr[i] = cr * pr - ci * pi; sCAi[i] = cr * pi + ci * pr; }
        __syncthreads();
        { const int d = tid >> 8, c = (tid >> 4) & 15, cp = tid & 15; float acc = 0.f;
#pragma unroll 8
          for (int p = 0; p < 64; ++p) acc += sCAr[(d * 16 + c) * 64 + p] * sBr[(d * 64 + p) * 16 + cp] - sCAi[(d * 16 + c) * 64 + p] * sBi[(d * 64 + p) * 16 + cp];
          sK[((d * 8 + ll) * 16 + c) * 16 + cp] = acc; }
        __syncthreads();
    }
    for (int pi_ = tid; pi_ < 8 * 32 * 2 * 32; pi_ += 512) {
        const int half = pi_ & 1, c = (pi_ >> 1) & 15, dir = (pi_ >> 5) & 1, j = (pi_ >> 6) & 31, ll = pi_ >> 11, l = 8 * qq + ll;
        if (l == 0 && dir == 1) continue;
        const int r = dir == 0 ? j - l : j + l;
        if (r < 0 || r > 31) continue;
        float v[8];
#pragma unroll
        for (int e = 0; e < 8; ++e) { const int cp = half * 8 + e; float x = sK[((dir * 8 + ll) * 16 + c) * 16 + cp];
            if (l == 0) { x += sK[((1 * 8 + 0) * 16 + c) * 16 + cp]; if (cp == c) x += dsk[g * 16 + c]; } v[e] = x; }
        u32x4 o; o.x = pk2(v[0], v[1]); o.y = pk2(v[2], v[3]); o.z = pk2(v[4], v[5]); o.w = pk2(v[6], v[7]);
        *(u32x4*)(OPY + ((size_t)g * 512 + j * 16 + c) * UXLD + r * 16 + half * 8) = o;
    }
    for (int pi_ = tid; pi_ < 8 * 16 * 32; pi_ += 512) {
        const int p8 = pi_ & 7, ri = (pi_ >> 3) & 1, d = (pi_ >> 4) & 1, c = (pi_ >> 5) & 15, jj = pi_ >> 9, j = 8 * qq + jj, e = d == 0 ? j + 1 : 32 - j;
        float v[8];
#pragma unroll
        for (int k = 0; k < 8; ++k) { const int p = p8 * 8 + k; const float cr = sCr[(d * 16 + c) * 64 + p], ci = sCi[(d * 16 + c) * 64 + p], pr = sPr[(d * 33 + e) * 64 + p], pim = sPi[(d * 33 + e) * 64 + p];
            v[k] = ri == 0 ? cr * pr - ci * pim : -(cr * pim + ci * pr); }
        u32x4 o; o.x = pk2(v[0], v[1]); o.y = pk2(v[2], v[3]); o.z = pk2(v[4], v[5]); o.w = pk2(v[6], v[7]);
        *(u32x4*)(OPY + ((size_t)g * 512 + j * 16 + c) * UXLD + 512 + d * 128 + ri * 64 + p8 * 8) = o;
    }
    for (int pi_ = tid; pi_ < 256 * 8 * 2; pi_ += 512) {
        const int half = pi_ & 1, rr = (pi_ >> 1) & 7, n = pi_ >> 4, d = n >> 7, ri = (n >> 6) & 1, p = n & 63, r = 8 * qq + rr, e = d == 0 ? 31 - r : r;
        const float pr = sPr[(d * 33 + e) * 64 + p], pim = sPi[(d * 33 + e) * 64 + p];
        float v[8];
#pragma unroll
        for (int k = 0; k < 8; ++k) { const int cp = half * 8 + k; const float br = sBr[(d * 64 + p) * 16 + cp], bi = sBi[(d * 64 + p) * 16 + cp]; v[k] = ri == 0 ? pr * br - pim * bi : pr * bi + pim * br; }
        u32x4 o; o.x = pk2(v[0], v[1]); o.y = pk2(v[2], v[3]); o.z = pk2(v[4], v[5]); o.w = pk2(v[6], v[7]);
        *(u32x4*)(OPS + ((size_t)g * 256 + n) * 512 + r * 16 + half * 8) = o;
    }
    __syncthreads();
}

__device__ __forceinline__ void p0_gemv_item(const Args& a, LAS unsigned char* lds, int item, int tid, int wave, int lane) {
    LAS float* sS = (LAS float*)lds;
    LAS float* sR = sS + 6144;
    const float* cvec = a.in[1]; const float* cctx = a.in[3]; const float* w_ada = a.in[4];
    for (int i = tid; i < 6144; i += 512) { const float v = i < 4096 ? cvec[i] : cctx[i - 4096]; sS[i] = v / (1.f + expf(-v)); }
    __syncthreads();
    const int ct = item >> 1, kh = item & 1, k0 = kh * 1024 + wave * 128;
    const float* wp = w_ada + (size_t)k0 * 6144 + ct * 64 + lane;
    float a0 = 0.f, a1 = 0.f, a2 = 0.f;
#pragma unroll 16
    for (int k = 0; k < 128; ++k) { const float w = wp[(size_t)k * 6144]; a0 += sS[k0 + k] * w; a1 += sS[2048 + k0 + k] * w; a2 += sS[4096 + k0 + k] * w; }
    sR[(wave * 3 + 0) * 64 + lane] = a0; sR[(wave * 3 + 1) * 64 + lane] = a1; sR[(wave * 3 + 2) * 64 + lane] = a2;
    __syncthreads();
    if (tid < 192) { const int r = tid >> 6, l = tid & 63; float s = 0.f;
#pragma unroll
        for (int w = 0; w < 8; ++w) s += sR[(w * 3 + r) * 64 + l];
        ((float*)(a.ws + WS_MODP))[(kh * 3 + r) * 6144 + ct * 64 + l] = s; }
    __syncthreads();
}

__global__ void __launch_bounds__(NWAVES * 64, 2) fused_fwd(Args args) {
    extern __shared__ __attribute__((aligned(16))) unsigned char lds_raw[];
    LAS unsigned char* lds = (LAS unsigned char*)lds_raw;
    volatile LAS unsigned* MISC = (volatile LAS unsigned*)(lds + MISC_OFF);
    const int tid = threadIdx.x, lane = tid & 63, wave = __builtin_amdgcn_readfirstlane(tid >> 6);
    const int G = gridDim.x, bx = blockIdx.x;
    const int vcu = (G % 8 == 0) ? (bx % 8) * (G / 8) + bx / 8 : bx;
    unsigned char* ws = args.ws;
    gu32* ctl = (gu32*)(ws + WS_CTL);
    for (int u = tid; u < (LDS_BYTES - RING_BYTES) / 4; u += NWAVES * 64) ((LAS unsigned*)(lds + RING_BYTES))[u] = 0u;
    __syncthreads();
    XcdBarrier bar = xcd_barrier_post((unsigned*)(ctl + CW_BAR), MISC + 8);

    const float* x = args.in[0]; const float* ctx = args.in[2]; const float* b_ada = args.in[5];
    bf16_t* HMOD = (bf16_t*)(ws + WS_HMOD); bf16_t* WIN = (bf16_t*)(ws + WS_WIN); bf16_t* WOUT = (bf16_t*)(ws + WS_WOUT); bf16_t* WGLU = (bf16_t*)(ws + WS_WGLU); bf16_t* WSP = (bf16_t*)(ws + WS_WSP);
    bf16_t* GU = (bf16_t*)(ws + WS_GU); bf16_t* GV = (bf16_t*)(ws + WS_GV); bf16_t* SZA = (bf16_t*)(ws + WS_SZA); bf16_t* SZB = (bf16_t*)(ws + WS_SZB);
    float* VST = (float*)(ws + WS_VST); bf16_t* UX = (bf16_t*)(ws + WS_UX); float* Z = (float*)(ws + WS_Z); bf16_t* YG = (bf16_t*)(ws + WS_YG); bf16_t* YCAT = (bf16_t*)(ws + WS_YCAT);
    const float* MODP = (const float*)(ws + WS_MODP); float* MODF = (float*)(ws + WS_MODF);
    const int gw = vcu * NWAVES + wave, NGW = G * NWAVES;

    {
        for (int it = bx; it < 256; it += G) p0_s5_item(args, lds, it >> 2, it & 3, tid);
        for (int it = bx; it < 192; it += G) p0_gemv_item(args, lds, it, tid, wave, lane);
        LAS float* scr = (LAS float*)(lds + wave * 16384);
        constexpr int I_IN = (DM / 64) * (INC / 32), I_OUT = (DM / 64) * (DM / 32), I_GLU = (WB / 64) * (WB / 32);
        for (int it = gw; it < I_IN + I_OUT + I_GLU; it += NGW) {
            int r = it;
            if (r < I_IN) { p0_transpose_item(args.in[6], DM, INC, WIN, scr, r, lane); continue; } r -= I_IN;
            if (r < I_OUT) { p0_transpose_item(args.in[21], DM, DM, WOUT, scr, r, lane); continue; } r -= I_OUT;
            p0_transpose_item(args.in[19], WB, WB, WGLU, scr, r, lane);
        }
        const float* wsp = args.in[9];
        for (int i = gw * 64 + lane; i < NH * 128 * 128 / 4; i += NGW * 64) { const f32x4 v = *(const f32x4*)(wsp + (size_t)i * 4); u32x2 o; o.x = pk2(v[0], v[1]); o.y = pk2(v[2], v[3]); *(u32x2*)(WSP + (size_t)i * 4) = o; }
    }
    xcd_barrier(bar);

    {
        if (bx == 0) for (int i = tid; i < 3 * 6144; i += 512) MODF[i] = MODP[i] + MODP[3 * 6144 + i] + b_ada[i % 6144];
        int curb = -1; f32x4 sh[8], sc[8];
        for (int row = gw; row < M + MC; row += NGW) {
            const int r = row < M ? (row >= SEQ ? 1 : 0) : 2;
            if (r != curb) { curb = r;
#pragma unroll
                for (int j = 0; j < 8; ++j) { const int col = 4 * (lane + 64 * j);
                    sh[j] = *(const f32x4*)(MODP + r * 6144 + col) + *(const f32x4*)(MODP + (3 + r) * 6144 + col) + *(const f32x4*)(b_ada + col);
                    sc[j] = *(const f32x4*)(MODP + r * 6144 + DM + col) + *(const f32x4*)(MODP + (3 + r) * 6144 + DM + col) + *(const f32x4*)(b_ada + DM + col) + 1.0f; } }
            const float* src = row < M ? x + (size_t)row * DM : ctx + (size_t)(row - M) * DM;
            f32x4 v[8]; float s = 0.f;
#pragma unroll
            for (int j = 0; j < 8; ++j) { v[j] = *(const f32x4*)(src + 4 * (lane + 64 * j)); s += (v[j][0] + v[j][1]) + (v[j][2] + v[j][3]); }
            const float mean = wave_sum(s) * (1.f / DM); float q = 0.f;
#pragma unroll
            for (int j = 0; j < 8; ++j) { v[j] = v[j] - mean; q += (v[j][0] * v[j][0] + v[j][1] * v[j][1]) + (v[j][2] * v[j][2] + v[j][3] * v[j][3]); }
            const float rstd = 1.f / sqrtf(wave_sum(q) * (1.f / DM) + LN_EPS);
            bf16_t* dst = HMOD + (size_t)row * DM;
#pragma unroll
            for (int j = 0; j < 8; ++j) { const f32x4 o = v[j] * rstd * sc[j] + sh[j]; u32x2 w; w.x = cvt_pk_bf16(o[0], o[1]); w.y = cvt_pk_bf16(o[2], o[3]); *(u32x2*)(dst + 4 * (lane + 64 * j)) = w; }
        }
    }
    xcd_barrier(bar);

    {
        pg8::Geom g{DM / 64, DM * 2, DM * 2, 128, 128, 0};
        Sched1 S; S.so.init(64, 20, G, bx); S.A = (const char*)HMOD; S.Bt = (const char*)WIN;
        Epi1 E{GU, GV, SZA, SZB, UX, VST};
        pg8::gemm_phase<Epi1, Sched1, 0, true, true>(lds, g, S, E);
    }
    xcd_barrier(bar);

    {
        pg8::Geom g{512 / 64, UXLD * 2, 512 * 2, 128, 128, 0};
        SchedZ S{(const char*)UX, (const char*)(ws + WS_OPS), bx};
        EpiZ E{Z};
        pg8::gemm_phase<EpiZ, SchedZ, 0, false, true>(lds, g, S, E);
    }
    xcd_barrier(bar);

    {
        if (bx < 64 && tid < 256) {
            const int g = bx, d = tid >> 7, b = (tid >> 6) & 1, p = tid & 63;
            const float* A32 = (const float*)(ws + WS_A32);
            const float ar = A32[((g * 2 + d) * 2 + 0) * 64 + p], ai = A32[((g * 2 + d) * 2 + 1) * 64 + p];
            const float* Zg = Z + (size_t)g * UXROWS * 256 + d * 128 + p;
            bf16_t* Hg = UX + ((size_t)g * UXROWS + 16) * UXLD + 512 + d * 128 + p;
            float hr = 0.f, hi = 0.f;
            for (int kc = 0; kc < 8; ++kc) { const int row = b * 8 + (d == 0 ? kc : 7 - kc); const float zr = Zg[(size_t)row * 256], zi = Zg[(size_t)row * 256 + 64];
                const float nr = ar * hr - ai * hi + zr, ni = ar * hi + ai * hr + zi; hr = nr; hi = ni; }
            for (int k0 = 0; k0 < 256; k0 += 8) {
                float zr[8], zi[8];
#pragma unroll
                for (int e = 0; e < 8; ++e) { const int k = d == 0 ? k0 + e : 255 - k0 - e; const size_t row = 16 + b * 256 + k; zr[e] = Zg[row * 256]; zi[e] = Zg[row * 256 + 64]; }
#pragma unroll
                for (int e = 0; e < 8; ++e) { const int k = d == 0 ? k0 + e : 255 - k0 - e; bf16_t* hp = Hg + (size_t)(b * 256 + k) * UXLD;
                    hp[0] = (bf16_t)f2bf(hr); hp[64] = (bf16_t)f2bf(hi);
                    const float nr = ar * hr - ai * hi + zr[e], ni = ar * hi + ai * hr + zi[e]; hr = nr; hi = ni; }
            }
        }
        LAS bf16_t* vT = (LAS bf16_t*)lds;
        LAS float* sSt = (LAS float*)(lds + 128 * 136 * 2);
        const float* lng = args.in[7]; const float* lnb = args.in[8]; const float* bsp = args.in[10];
        for (int unit = bx; unit < 1024; unit += G) {
            const int n = unit >> 3, h = unit & 7; const size_t row0 = (size_t)n * 128;
            if (tid < 128) { const f32x4* sp = (const f32x4*)(VST + (row0 + tid) * 32); float s = 0.f, q = 0.f;
#pragma unroll
                for (int i = 0; i < 8; ++i) { const f32x4 t = sp[i]; s += t[0] + t[2]; q += t[1] + t[3]; }
                const float mu = s * (1.f / WA), var = q * (1.f / WA) - mu * mu; sSt[tid] = mu; sSt[128 + tid] = 1.f / sqrtf(var + LN_EPS); }
            __syncthreads();
            { const int q = tid & 127, dq = tid >> 7; const float mu = sSt[q], rstd = sSt[128 + q];
              const bf16_t* src = GV + (row0 + q) * 1024 + h * 128 + dq * 32;
#pragma unroll
              for (int i = 0; i < 4; ++i) { const u32x4 v = *(const u32x4*)(src + 8 * i); const int d0 = dq * 32 + 8 * i;
                  const f32x4 g0 = *(const f32x4*)(lng + h * 128 + d0), g1 = *(const f32x4*)(lng + h * 128 + d0 + 4), b0 = *(const f32x4*)(lnb + h * 128 + d0), b1 = *(const f32x4*)(lnb + h * 128 + d0 + 4);
                  float o[8]; o[0] = (bflo(v.x) - mu) * rstd * g0[0] + b0[0]; o[1] = (bfhi(v.x) - mu) * rstd * g0[1] + b0[1]; o[2] = (bflo(v.y) - mu) * rstd * g0[2] + b0[2]; o[3] = (bfhi(v.y) - mu) * rstd * g0[3] + b0[3];
                  o[4] = (bflo(v.z) - mu) * rstd * g1[0] + b1[0]; o[5] = (bfhi(v.z) - mu) * rstd * g1[1] + b1[1]; o[6] = (bflo(v.w) - mu) * rstd * g1[2] + b1[2]; o[7] = (bfhi(v.w) - mu) * rstd * g1[3] + b1[3];
#pragma unroll
                  for (int e = 0; e < 8; ++e) vT[(d0 + e) * 136 + q] = (bf16_t)f2bf(o[e]); } }
            __syncthreads();
            { const int wd = wave >> 2, wp = wave & 3, l15 = lane & 15, l4 = lane >> 4;
              f32x4 acc[4][2];
#pragma unroll
              for (int dt = 0; dt < 4; ++dt)
#pragma unroll
                  for (int pt = 0; pt < 2; ++pt) acc[dt][pt] = (f32x4){0.f, 0.f, 0.f, 0.f};
#pragma unroll
              for (int ks = 0; ks < 4; ++ks) {
                  bf16x8 bfr[2], afr[4];
#pragma unroll
                  for (int pt = 0; pt < 2; ++pt) bfr[pt] = *(const bf16x8*)(WSP + ((size_t)h * 128 + wp * 32 + pt * 16 + l15) * 128 + ks * 32 + l4 * 8);
#pragma unroll
                  for (int dt = 0; dt < 4; ++dt) afr[dt] = *(const LAS bf16x8*)(vT + (wd * 64 + dt * 16 + l15) * 136 + ks * 32 + l4 * 8);
#pragma unroll
                  for (int dt = 0; dt < 4; ++dt)
#pragma unroll
                      for (int pt = 0; pt < 2; ++pt) acc[dt][pt] = __builtin_amdgcn_mfma_f32_16x16x32_bf16(afr[dt], bfr[pt], acc[dt][pt], 0, 0, 0);
              }
#pragma unroll
              for (int pt = 0; pt < 2; ++pt) { const int pl = wp * 32 + pt * 16 + l15; const float bsv = bsp[h * 128 + pl]; const size_t tok = row0 + pl;
#pragma unroll
                  for (int dt = 0; dt < 4; ++dt) { const int col = h * 128 + wd * 64 + dt * 16 + l4 * 4;
                      const u32x2 uv = *(const u32x2*)(GU + tok * 1024 + col), zv = *(const u32x2*)(SZA + tok * 1024 + col); const f32x4 mx = acc[dt][pt] + bsv;
                      u32x2 w; w.x = cvt_pk_bf16(bflo(uv.x) * mx[0] * bflo(zv.x), bfhi(uv.x) * mx[1] * bfhi(zv.x)); w.y = cvt_pk_bf16(bflo(uv.y) * mx[2] * bflo(zv.y), bfhi(uv.y) * mx[3] * bfhi(zv.y));
                      *(u32x2*)(YCAT + tok * 2048 + col) = w; } } }
            __syncthreads();
        }
    }
    xcd_barrier(bar);

    {
        pg8::Geom g{UXLD / 64, UXLD * 2, UXLD * 2, 128, 128, 0};
        SchedY S{(const char*)UX, (const char*)(ws + WS_OPY), bx};
        EpiY E{YG};
        pg8::gemm_phase<EpiY, SchedY, 0, false, true>(lds, g, S, E);
    }
    xcd_barrier(bar);

    {
        pg8::Geom g{WB / 64, 0, WB * 2, (size_t)4 * M * 32, 128, (unsigned)(M * 32)};
        SchedG S; S.so.init(64, 4, G, bx); S.YG = (const char*)YG; S.Bt = (const char*)WGLU;
        EpiG E{YG, SZB, args.in[20], YCAT};
        pg8::gemm_phase<EpiG, SchedG, 1, false, true>(lds, g, S, E);
    }
    xcd_barrier(bar);

    {
        pg8::Geom g{DM / 64, DM * 2, DM * 2, 128, 128, 0};
        SchedO S; S.so.init(64, 8, G, bx); S.A = (const char*)YCAT; S.Bt = (const char*)WOUT;
        EpiO E{x, MODF, args.out};
        pg8::gemm_phase<EpiO, SchedO, 0, true, true>(lds, g, S, E);
    }
    xcd_barrier(bar);

    {
        const float* lg = args.in[22]; const float* lb = args.in[23];
        for (int row = gw; row < M; row += NGW) {
            float* p = args.out + (size_t)row * DM;
            f32x4 v[8]; float s = 0.f;
#pragma unroll
            for (int j = 0; j < 8; ++j) { v[j] = *(const f32x4*)(p + 4 * (lane + 64 * j)); s += (v[j][0] + v[j][1]) + (v[j][2] + v[j][3]); }
            const float mean = wave_sum(s) * (1.f / DM); float q = 0.f;
#pragma unroll
            for (int j = 0; j < 8; ++j) { v[j] = v[j] - mean; q += (v[j][0] * v[j][0] + v[j][1] * v[j][1]) + (v[j][2] * v[j][2] + v[j][3] * v[j][3]); }
            const float rstd = 1.f / sqrtf(wave_sum(q) * (1.f / DM) + LN_EPS);
#pragma unroll
            for (int j = 0; j < 8; ++j) { const int col = 4 * (lane + 64 * j); *(f32x4*)(p + col) = v[j] * rstd * *(const f32x4*)(lg + col) + *(const f32x4*)(lb + col); }
        }
    }
}

extern "C" void kernel_launch(void* const* d_in, const int* in_sizes, int n_in, void* d_out, int out_size, void* d_ws, size_t ws_size, hipStream_t stream) {
    static int grid = 0;
    if (grid == 0) {
        if (n_in != 24 || out_size != M * DM || ws_size < WS_END) { fprintf(stderr, "kernel_launch: unexpected shapes (n_in %d, out %d, ws %zu)\n", n_in, out_size, ws_size); grid = -1; return; }
        int dev = 0, cus = 0, per_cu = 0;
        if (hipGetDevice(&dev) != hipSuccess || hipDeviceGetAttribute(&cus, hipDeviceAttributeMultiprocessorCount, dev) != hipSuccess) { grid = -1; return; }
        if (hipFuncSetAttribute((const void*)fused_fwd, hipFuncAttributeMaxDynamicSharedMemorySize, LDS_BYTES) != hipSuccess) { fprintf(stderr, "kernel_launch: hipFuncSetAttribute failed\n"); grid = -1; return; }
        if (hipOccupancyMaxActiveBlocksPerMultiprocessor(&per_cu, (const void*)fused_fwd, NWAVES * 64, LDS_BYTES) != hipSuccess || per_cu < 1) { fprintf(stderr, "kernel_launch: occupancy query says %d\n", per_cu); }
        (void)hipGetLastError();
        grid = cus;
    }
    if (grid < 0) return;
    (void)hipMemsetAsync((char*)d_ws + WS_CTL, 0, CTL_ZERO_BYTES, stream);
    Args a{};
    for (int i = 0; i < 24; ++i) a.in[i] = (const float*)d_in[i];
    a.out = (float*)d_out; a.ws = (unsigned char*)d_ws;
    hipLaunchKernelGGL(fused_fwd, dim3(grid), dim3(NWAVES * 64), LDS_BYTES, stream, a);
}
```
